# Optimizing an MI355X kernel written in HIP

```python
import jax, jax.numpy as jnp
from jax import lax
import numpy as np

D_MODEL = 1024
BATCH = 2
SEQ = 8192
DEPTH = 1

CHUNK = 64
EPS = 1e-6

ATT_HEADS = 16
ATT_KV_HEADS = 2
HEAD_DIM = 64
ATT_GROUP = ATT_HEADS // ATT_KV_HEADS
ATT_WIDTH = ATT_HEADS * HEAD_DIM
KV_WIDTH = ATT_KV_HEADS * HEAD_DIM
WINDOW = 128
WINDOW_CHUNKS = WINDOW // CHUNK
KEY_BLOCK = (WINDOW_CHUNKS + 1) * CHUNK
ROPE_DIM = HEAD_DIM // 4
ROPE_THETA = 500000.0

SG_BLOCK = 128
SG_GROUPS = 8
SG_WIDTH = 1024
SG_GROUP_WIDTH = SG_WIDTH // SG_GROUPS

N_BRANCHES = 2
IN_SIZES = [ATT_WIDTH, KV_WIDTH, KV_WIDTH, ATT_WIDTH,
            SG_WIDTH, SG_WIDTH, SG_WIDTH,
            N_BRANCHES * D_MODEL]
IN_WIDTH = int(sum(IN_SIZES))
IN_SPLITS = [int(s) for s in np.cumsum(IN_SIZES)[:-1]]

kernel_name = "hybrid_swa_sink_gmlp_gated_block"


def rmsnorm(x, g):
    xf = x.astype(jnp.float32)
    y = xf * lax.rsqrt(jnp.mean(xf * xf, axis=-1, keepdims=True) + EPS)
    return (y * g.astype(jnp.float32)).astype(x.dtype)


def layernorm(x, g, b):
    xf = x.astype(jnp.float32)
    mu = jnp.mean(xf, axis=-1, keepdims=True)
    xc = xf - mu
    y = xc * lax.rsqrt(jnp.mean(xc * xc, axis=-1, keepdims=True) + EPS)
    return (y * g.astype(jnp.float32) + b.astype(jnp.float32)).astype(x.dtype)


def partial_rope(x, pos):
    half = ROPE_DIM // 2
    inv_freq = ROPE_THETA ** (-(jnp.arange(half, dtype=jnp.float32) * 2.0) / ROPE_DIM)
    ang = pos.astype(jnp.float32)[:, None] * inv_freq[None, :]
    cos = jnp.cos(ang)[None, :, None, :]
    sin = jnp.sin(ang)[None, :, None, :]
    xf = x.astype(jnp.float32)
    x1, x2, rest = xf[..., :half], xf[..., half:ROPE_DIM], xf[..., ROPE_DIM:]
    out = jnp.concatenate([x1 * cos - x2 * sin, x2 * cos + x1 * sin, rest], axis=-1)
    return out.astype(x.dtype)


def window_sink_attention(q, k, v, sinks):
    B, S = q.shape[0], q.shape[1]
    nc = S // CHUNK
    qc = q.reshape(B, nc, CHUNK, ATT_KV_HEADS, ATT_GROUP, HEAD_DIM)
    pad = ((0, 0), (WINDOW_CHUNKS, 0), (0, 0), (0, 0), (0, 0))
    kc = jnp.pad(k.reshape(B, nc, CHUNK, ATT_KV_HEADS, HEAD_DIM), pad)
    vc = jnp.pad(v.reshape(B, nc, CHUNK, ATT_KV_HEADS, HEAD_DIM), pad)
    kb = jnp.concatenate([kc[:, j:j + nc] for j in range(WINDOW_CHUNKS + 1)], axis=2)
    vb = jnp.concatenate([vc[:, j:j + nc] for j in range(WINDOW_CHUNKS + 1)], axis=2)
    s = jnp.einsum('bnqhgd,bnkhd->bhgnqk', qc, kb,
                   preferred_element_type=jnp.float32) * (HEAD_DIM ** -0.5)
    key_chunk = jnp.arange(nc)[:, None] - WINDOW_CHUNKS + jnp.arange(WINDOW_CHUNKS + 1)[None, :]
    valid = jnp.repeat(key_chunk >= 0, CHUNK, axis=1)
    s = jnp.where(valid[None, None, None, :, None, :], s, -1e30)
    sink = sinks.astype(jnp.float32).reshape(ATT_KV_HEADS, ATT_GROUP)[None, :, :, None, None, None]
    m = jnp.maximum(jnp.max(s, axis=-1, keepdims=True), sink)
    p = jnp.exp(s - m)
    denom = jnp.sum(p, axis=-1, keepdims=True) + jnp.exp(sink - m)
    o = jnp.einsum('bhgnqk,bnkhd->bnqhgd', p / denom, vb.astype(jnp.float32))
    return o.reshape(B, S, ATT_WIDTH).astype(q.dtype)


def chunked_spatial_gating(u, v, w_s, b_s, ln_g, ln_b):
    B, S = u.shape[0], u.shape[1]
    nb = S // SG_BLOCK
    v = layernorm(v, ln_g, ln_b)
    vb = v.reshape(B, nb, SG_BLOCK, SG_GROUPS, SG_GROUP_WIDTH)
    cidx = np.arange(SG_BLOCK) // CHUNK
    mask = jnp.asarray(cidx[None, :] <= cidx[:, None])
    w = jnp.where(mask[None], w_s, jnp.zeros_like(w_s))
    mixed = jnp.einsum('gij,bnjgc->bnigc', w, vb) + jnp.transpose(b_s)[None, None, :, :, None]
    return u * mixed.reshape(B, S, SG_WIDTH)


def setup_inputs(seed: int = 0) -> dict:
    key = jax.random.key(seed)
    ks = jax.random.split(key, 16)
    f32 = jnp.float32
    d = D_MODEL
    x = jax.random.normal(ks[0], (BATCH, SEQ, d), f32)
    norm_g = 1.0 + 0.05 * jax.random.normal(ks[1], (DEPTH, d), f32)
    w_in = jax.random.normal(ks[2], (DEPTH, d, IN_WIDTH), f32) * d ** -0.5
    b_merge = 0.01 * jax.random.normal(ks[3], (DEPTH, N_BRANCHES * d), f32)
    att_sinks = 0.5 * jax.random.normal(ks[4], (DEPTH, ATT_HEADS), f32)
    sg_w = jax.random.normal(ks[5], (DEPTH, SG_GROUPS, SG_BLOCK, SG_BLOCK), f32) * (0.5 * SG_BLOCK ** -0.5)
    sg_b = 1.0 + 0.1 * jax.random.normal(ks[6], (DEPTH, SG_GROUPS, SG_BLOCK), f32)
    sg_ln_g = 1.0 + 0.05 * jax.random.normal(ks[7], (DEPTH, SG_WIDTH), f32)
    sg_ln_b = 0.02 * jax.random.normal(ks[8], (DEPTH, SG_WIDTH), f32)
    w_att_out = jax.random.normal(ks[9], (DEPTH, ATT_WIDTH, d), f32) * ATT_WIDTH ** -0.5
    w_sg_out = jax.random.normal(ks[10], (DEPTH, SG_WIDTH, d), f32) * SG_WIDTH ** -0.5
    w_o = jax.random.normal(ks[11], (DEPTH, d, d), f32) * d ** -0.5
    final_g = 1.0 + 0.05 * jax.random.normal(ks[12], (d,), f32)
    return {"x": x, "norm_g": norm_g, "w_in": w_in, "b_merge": b_merge,
            "att_sinks": att_sinks, "sg_w": sg_w, "sg_b": sg_b, "sg_ln_g": sg_ln_g,
            "sg_ln_b": sg_ln_b, "w_att_out": w_att_out, "w_sg_out": w_sg_out,
            "w_o": w_o, "final_g": final_g}


def reference(x, norm_g, w_in, b_merge, att_sinks, sg_w, sg_b, sg_ln_g, sg_ln_b,
              w_att_out, w_sg_out, w_o, final_g):
    B, S = x.shape[0], x.shape[1]
    pos = jnp.arange(S)
    for l in range(DEPTH):
        h = rmsnorm(x, norm_g[l])
        proj = h @ w_in[l]
        q, k, v, za, u, vs, zs, gm = jnp.split(proj, IN_SPLITS, axis=-1)
        q = partial_rope(q.reshape(B, S, ATT_HEADS, HEAD_DIM), pos)
        k = partial_rope(k.reshape(B, S, ATT_KV_HEADS, HEAD_DIM), pos)
        v = v.reshape(B, S, ATT_KV_HEADS, HEAD_DIM)
        a = window_sink_attention(q, k, v, att_sinks[l])
        a = (a * jax.nn.silu(za)) @ w_att_out[l]
        sgo = chunked_spatial_gating(jax.nn.gelu(u, approximate=False),
                                     jax.nn.gelu(vs, approximate=False),
                                     sg_w[l], sg_b[l], sg_ln_g[l], sg_ln_b[l])
        sgo = (sgo * jax.nn.silu(zs)) @ w_sg_out[l]
        ga, gs = jnp.split(jax.nn.sigmoid(gm + b_merge[l]), N_BRANCHES, axis=-1)
        y = ga * a + gs * sgo
        x = x + y @ w_o[l]
    return rmsnorm(x, final_g)
```

```cpp
#include <hip/hip_runtime.h>
#include <hip/hip_cooperative_groups.h>
#include <cstdio>
#include <cstdint>

#ifndef DIAG
#define DIAG 0
#endif
#define LAS __attribute__((address_space(3)))
#define GAS __attribute__((address_space(1)))
typedef unsigned short bf16_t;
typedef short bf16x8 __attribute__((ext_vector_type(8)));
typedef float f32x4 __attribute__((ext_vector_type(4)));
typedef float f32x2 __attribute__((ext_vector_type(2)));
typedef unsigned u32x4 __attribute__((ext_vector_type(4)));
typedef unsigned u32x2 __attribute__((ext_vector_type(2)));

constexpr int M = 16384, D = 1024, SEQ = 8192, NIN = 7424, LDP = 7424;
constexpr int C_Q = 0, C_K = 1024, C_V = 1152, C_ZA = 1280, C_U = 2304, C_VS = 3328, C_ZS = 4352, C_GA = 5376, C_GS = 6400;
constexpr float EPS = 1e-6f;
constexpr float QSCALE = 0.18033688011112042f;
constexpr float LOG2E = 1.4426950408889634f;
__device__ __constant__ float CREV[8] = {0.15915494309189535f, 0.03086376340470123f, 0.005985185712713705f, 0.001160663641240061f,
                                         0.00022507907903927653f, 4.364795279280289e-05f, 8.464330808241401e-06f, 1.6414262627950345e-06f};

constexpr size_t MiB = 1u << 20;
constexpr size_t WS_CTL = 0, CTL_ZERO_BYTES = 64 * 1024;
constexpr size_t WS_WIN = 1 * MiB;
constexpr size_t WS_WA = WS_WIN + (size_t)NIN * D * 2;
constexpr size_t WS_WS = WS_WA + 2 * MiB, WS_WO = WS_WS + 2 * MiB, WS_SGW = WS_WO + 2 * MiB;
constexpr size_t WS_SSQ = WS_SGW + 256 * 1024;
constexpr size_t WS_P = 23 * MiB;
constexpr size_t WS_END = WS_P + (size_t)M * LDP * 2;
static_assert(WS_SSQ + (size_t)M * 16 * 4 <= WS_P && WS_END <= 256 * MiB, "d_ws map");
constexpr size_t OUT_XN = 0, OUT_STATS = 32 * MiB;
constexpr int CW_BAR = 4096;

__device__ __forceinline__ unsigned cvt_pk_bf16(float lo, float hi) { unsigned r; asm volatile("s_nop 0\n\tv_cvt_pk_bf16_f32 %0, %1, %2" : "=v"(r) : "v"(lo), "v"(hi)); return r; }
__device__ __forceinline__ float bf_lo(unsigned w) { return __uint_as_float(w << 16); }
__device__ __forceinline__ float bf_hi(unsigned w) { return __uint_as_float(w & 0xffff0000u); }
__device__ __forceinline__ f32x2 gelu_pk(f32x2 v) {
    const f32x2 av = __builtin_elementwise_abs(v), d = av * 0.2316418882f + 1.0f;
    f32x2 t; t.x = __builtin_amdgcn_rcpf(d.x); t.y = __builtin_amdgcn_rcpf(d.y);
    f32x2 q = t * 0.5307027145f + (-0.7265760135f); q = q * t + 0.7107068705f; q = q * t + (-0.142248368f); q = q * t + 0.127414796f; q = q * t;
    const f32x2 s = (v * v) * (-0.72134752044f);
    f32x2 e; e.x = __builtin_amdgcn_exp2f(s.x); e.y = __builtin_amdgcn_exp2f(s.y);
    const f32x2 m = v * (q * e), r = v - m;
    f32x2 o; o.x = v.x < 0.f ? m.x : r.x; o.y = v.y < 0.f ? m.y : r.y; return o;
}
__device__ __forceinline__ float sigmoid_f(float x) { return __builtin_amdgcn_rcpf(1.0f + __builtin_amdgcn_exp2f(-LOG2E * x)); }
__device__ __forceinline__ float wave_sum(float v) {
#pragma unroll
    for (int o = 1; o < 64; o <<= 1) v += __shfl_xor(v, o);
    return v;
}

namespace pg8 {
constexpr int BM = 256, BK = 64, HALF = 128, HTB = HALF * BK * 2, STAGE_BYTES = 8 * HTB, NXCD = 8, WGM = 8;
__host__ __device__ __forceinline__ int lds_byte(int r, int c) { const int st = (r >> 4) * 2 + (c >> 5), rr = r & 15, cc = c & 31, ob = rr * 64 + cc * 2; return st * 1024 + (ob ^ (((ob >> 9) & 1) << 5)); }
__host__ __device__ __forceinline__ void stage_rc(int b, int& R, int& C) { const int st = b / 1024, sb = b % 1024, swz = sb ^ (((sb >> 9) & 1) << 5); R = (st >> 1) * 16 + swz / 64; C = (st & 1) * 32 + (swz % 64) / 2; }
__host__ __device__ __forceinline__ int perm32(int rho) { const int n = rho >> 4, i = rho & 15; return 8 * (i >> 2) + 4 * n + (i & 3); }

struct Unit { int pm, pn, src; };
struct Gemm { const bf16_t* A0; const bf16_t* B0; const bf16_t* A1; const bf16_t* B1; int lda, K; };

struct StaticOrder {
    int nM, nN, nwg, G, c;
    __device__ void init(int M_, int N_, int G_, int c_) { nM = M_ / BM; nN = N_ / BM; nwg = nM * nN; G = G_; c = c_; }
    __device__ bool tile(int i, Unit& u) const {
        const long L = (long)i * G + c; if (L >= nwg) return false;
        int wgid = (int)L; { const int q = nwg / NXCD, r = nwg % NXCD, xcd = wgid % NXCD, off = wgid / NXCD; wgid = (xcd < r ? xcd * (q + 1) : r * (q + 1) + (xcd - r) * q) + off; }
        const int nig = WGM * nN, gid = wgid / nig, fm = gid * WGM, gsz = (nM - fm) < WGM ? (nM - fm) : WGM;
        u.pm = fm + ((wgid % nig) % gsz); u.pn = (wgid % nig) / gsz; u.src = 0; return true;
    }
    __device__ bool next(int i, Unit& u) const { return tile(i, u); }
};
struct PairOrder {
    StaticOrder base;
    __device__ bool next(int i, Unit& u) const { const bool ok = base.tile(i >> 1, u); u.src = i & 1; return ok; }
};

template <class Epi, class Sched>
__device__ __forceinline__ void gemm_phase(LAS unsigned char* lds, const Gemm g, const Sched& S, const Epi& E) {
    const int tid = threadIdx.x, wid = __builtin_amdgcn_readfirstlane(tid >> 6), lane = tid & 63, wr = wid >> 2, wc = wid & 3, fr = lane & 15, fq = lane >> 4;
    const int K = g.K, nt = K / BK, lda = g.lda;
    unsigned voffA[2], voffB[2];
#pragma unroll
    for (int i = 0; i < 2; ++i) { int R, C; stage_rc(tid * 16 + i * 8192, R, C); const int Rb = Epi::PERM ? ((R & ~31) + perm32(R & 31)) : R;
        voffA[i] = (unsigned)(R * lda + C) * 2u; voffB[i] = (unsigned)(Rb * K + C) * 2u; }
    const size_t kstep = (size_t)(BK * 2);
    const size_t hstepA = (size_t)HALF * lda * 2, hstepB = (size_t)HALF * K * 2;
    const size_t tstepA = 2 * hstepA, tstepB = 2 * hstepB;
    const unsigned ldsw = (unsigned)wid * 1024u;
    const int aoff = lds_byte(wr * 64 + fr, fq * 8), boff = lds_byte(wc * 32 + fr, fq * 8);
#define PG8_SA(b, h) (((b) * 2 + (h)) * HTB)
#define PG8_SB(b, h) ((4 + (b) * 2 + (h)) * HTB)
#define PG8_STAGE(bufoff, gbase, voff) do { _Pragma("unroll") for (int _i = 0; _i < 2; ++_i) \
        __builtin_amdgcn_global_load_lds((const unsigned*)((const char*)(gbase) + (voff)[_i]), (LAS unsigned*)(lds + (bufoff) + ldsw + _i * 8192), 16, 0, 0); } while (0)
#define PG8_LDA(dst, b, h) do { _Pragma("unroll") for (int m = 0; m < 4; ++m) _Pragma("unroll") for (int k = 0; k < 2; ++k) dst[m][k] = *(const LAS bf16x8*)(lds + PG8_SA(b, h) + aoff + m * 2048 + k * 1024); } while (0)
#define PG8_LDB(dst, b, h) do { _Pragma("unroll") for (int n = 0; n < 2; ++n) _Pragma("unroll") for (int k = 0; k < 2; ++k) dst[n][k] = *(const LAS bf16x8*)(lds + PG8_SB(b, h) + boff + n * 2048 + k * 1024); } while (0)
#define PG8_MMA(ai, bj, At, Bt) do { __builtin_amdgcn_s_setprio(1); _Pragma("unroll") for (int m = 0; m < 4; ++m) _Pragma("unroll") for (int n = 0; n < 2; ++n) _Pragma("unroll") for (int k = 0; k < 2; ++k) \
        acc[ai][bj][m][n] = __builtin_amdgcn_mfma_f32_16x16x32_bf16(Bt[n][k], At[m][k], acc[ai][bj][m][n], 0, 0, 0); __builtin_amdgcn_s_setprio(0); } while (0)
#define PG8_WAIT_V(n) asm volatile("s_waitcnt vmcnt(" #n ")" ::: "memory")
#define PG8_WAIT_L(n) asm volatile("s_waitcnt lgkmcnt(" #n ")" ::: "memory")
#define PG8_BAR __builtin_amdgcn_s_barrier()
#define PG8_SCHED __builtin_amdgcn_sched_barrier(0)
#define PG8_BASE_A(u) ((const char*)((u).src ? g.A1 : g.A0) + (size_t)(u).pm * tstepA)
#define PG8_BASE_B(u) ((const char*)((u).src ? g.B1 : g.B0) + (size_t)(u).pn * tstepB)
    Unit cur, nxt; int ui = 0;
    if (!S.next(0, cur)) return;
    f32x4 acc[2][2][4][2];
#pragma unroll
    for (int a = 0; a < 2; ++a)
#pragma unroll
        for (int b = 0; b < 2; ++b)
#pragma unroll
            for (int m = 0; m < 4; ++m)
#pragma unroll
                for (int n = 0; n < 2; ++n) acc[a][b][m][n] = (f32x4){0.f, 0.f, 0.f, 0.f};
    bf16x8 At[4][2], B0[2][2], B1[2][2];
    const char* cA = PG8_BASE_A(cur); const char* cB = PG8_BASE_B(cur);
    PG8_STAGE(PG8_SB(0, 0), cB, voffB); PG8_STAGE(PG8_SB(0, 1), cB + hstepB, voffB); PG8_STAGE(PG8_SA(0, 0), cA, voffA); PG8_STAGE(PG8_SA(0, 1), cA + hstepA, voffA);
    if (wr == 1) PG8_BAR;
    PG8_WAIT_V(2); PG8_BAR;
    PG8_STAGE(PG8_SB(1, 0), cB + kstep, voffB); PG8_STAGE(PG8_SA(1, 0), cA + kstep, voffA); PG8_STAGE(PG8_SB(1, 1), cB + hstepB + kstep, voffB);
    PG8_WAIT_V(6); PG8_BAR;
    for (;;) {
        const bool has_next = S.next(ui + 1, nxt);
        const char* nA = has_next ? PG8_BASE_A(nxt) : cA; const char* nB = has_next ? PG8_BASE_B(nxt) : cB;
        for (int t = 0; t < nt; t += 2) {
            const bool last = (t == nt - 2);
            const char* a1 = cA + (size_t)(t + 1) * kstep;
            const char* a2 = last ? nA : cA + (size_t)(t + 2) * kstep; const char* b2 = last ? nB : cB + (size_t)(t + 2) * kstep;
            const char* a3 = a2 + kstep; const char* b3 = b2 + kstep;
            PG8_LDB(B0, 0, 0); PG8_LDB(B1, 0, 1); PG8_SCHED; PG8_LDA(At, 0, 0); PG8_STAGE(PG8_SA(1, 1), a1 + hstepA, voffA);
            PG8_WAIT_V(8); PG8_WAIT_L(0); PG8_BAR; PG8_MMA(0, 0, At, B0); PG8_MMA(0, 1, At, B1); PG8_BAR; PG8_SCHED;
            PG8_LDA(At, 0, 1); PG8_STAGE(PG8_SB(0, 0), b2, voffB); PG8_STAGE(PG8_SB(0, 1), b2 + hstepB, voffB); PG8_STAGE(PG8_SA(0, 0), a2, voffA);
            PG8_WAIT_V(8); PG8_WAIT_L(0); PG8_BAR; PG8_MMA(1, 0, At, B0); PG8_MMA(1, 1, At, B1); PG8_BAR; PG8_SCHED;
            PG8_LDB(B0, 1, 0); PG8_LDB(B1, 1, 1); PG8_SCHED; PG8_LDA(At, 1, 0); PG8_STAGE(PG8_SA(0, 1), a2 + hstepA, voffA);
            PG8_WAIT_V(8); PG8_WAIT_L(0); PG8_BAR; PG8_MMA(0, 0, At, B0); PG8_MMA(0, 1, At, B1); PG8_BAR; PG8_SCHED;
            PG8_LDA(At, 1, 1); PG8_STAGE(PG8_SB(1, 0), b3, voffB); PG8_STAGE(PG8_SB(1, 1), b3 + hstepB, voffB); PG8_STAGE(PG8_SA(1, 0), a3, voffA);
            PG8_WAIT_V(8); PG8_WAIT_L(0); PG8_BAR; PG8_MMA(1, 0, At, B0); PG8_MMA(1, 1, At, B1); PG8_BAR; PG8_SCHED;
        }
        if (wr == 0) PG8_BAR;
        const bool keep = E(acc, cur, wr, wc, fr, fq);
        if (!has_next) break;
        if (!keep) {
#pragma unroll
            for (int a = 0; a < 2; ++a)
#pragma unroll
                for (int b = 0; b < 2; ++b)
#pragma unroll
                    for (int m = 0; m < 4; ++m)
#pragma unroll
                        for (int n = 0; n < 2; ++n) acc[a][b][m][n] = (f32x4){0.f, 0.f, 0.f, 0.f};
        }
        cur = nxt; cA = nA; cB = nB; ++ui;
        if (wr == 1) PG8_BAR;
    }
    PG8_WAIT_V(0);
    PG8_BAR;
#undef PG8_SA
#undef PG8_SB
#undef PG8_STAGE
#undef PG8_LDA
#undef PG8_LDB
#undef PG8_MMA
#undef PG8_WAIT_V
#undef PG8_WAIT_L
#undef PG8_BAR
#undef PG8_SCHED
#undef PG8_BASE_A
#undef PG8_BASE_B
}

__device__ __forceinline__ void store8(bf16_t* p, const f32x4& v0, const f32x4& v1) {
    u32x4 w; w.x = cvt_pk_bf16(v0[0], v0[1]); w.y = cvt_pk_bf16(v0[2], v0[3]); w.z = cvt_pk_bf16(v1[0], v1[1]); w.w = cvt_pk_bf16(v1[2], v1[3]); *(u32x4*)p = w;
}
struct EpiProj {
    static constexpr bool PERM = true;
    bf16_t* P; const float* b_merge; float* stats;
    template <int MODE>
    __device__ __forceinline__ void act_tile(f32x4 (&acc)[2][2][4][2], const Unit& u, int wr, int wc, int fr, int fq) const {
        const int row0 = u.pm * BM + wr * 64 + fr, col0 = u.pn * BM + wc * 32 + 8 * fq;
        f32x4 bv[2][2];
        if (MODE == 4) {
#pragma unroll
            for (int bj = 0; bj < 2; ++bj)
#pragma unroll
                for (int n = 0; n < 2; ++n) bv[bj][n] = *(const f32x4*)(b_merge + (col0 - C_GA) + bj * HALF + 4 * n);
        }
#pragma unroll
        for (int ai = 0; ai < 2; ++ai)
#pragma unroll
            for (int m = 0; m < 4; ++m) {
                const int row = row0 + ai * HALF + m * 16; bf16_t* rowp = P + (size_t)row * LDP + col0;
                float s1 = 0.f, s2 = 0.f;
#pragma unroll
                for (int bj = 0; bj < 2; ++bj) {
                    f32x4 v0 = acc[ai][bj][m][0], v1 = acc[ai][bj][m][1];
                    if (MODE == 2 || MODE == 3) {
                        f32x2 a = gelu_pk((f32x2){v0[0], v0[1]}), b = gelu_pk((f32x2){v0[2], v0[3]}), c = gelu_pk((f32x2){v1[0], v1[1]}), d = gelu_pk((f32x2){v1[2], v1[3]});
                        v0 = (f32x4){a.x, a.y, b.x, b.y}; v1 = (f32x4){c.x, c.y, d.x, d.y};
                        if (MODE == 3) {
#pragma unroll
                            for (int e = 0; e < 4; ++e) { s1 += v0[e] + v1[e]; s2 += v0[e] * v0[e] + v1[e] * v1[e]; }
                        }
                    } else if (MODE == 1) {
#pragma unroll
                        for (int e = 0; e < 4; ++e) { v0[e] = v0[e] * sigmoid_f(v0[e]); v1[e] = v1[e] * sigmoid_f(v1[e]); }
                    } else if (MODE == 4) {
                        v0 = v0 + bv[bj][0]; v1 = v1 + bv[bj][1];
#pragma unroll
                        for (int e = 0; e < 4; ++e) { v0[e] = sigmoid_f(v0[e]); v1[e] = sigmoid_f(v1[e]); }
                    }
                    store8(rowp + bj * HALF, v0, v1);
                }
                if (MODE == 3) {
                    s1 += __shfl_xor(s1, 16); s1 += __shfl_xor(s1, 32); s2 += __shfl_xor(s2, 16); s2 += __shfl_xor(s2, 32);
                    if (fq == 0) *(f32x2*)(stats + (((size_t)(u.pn - C_VS / 256) * M + row) * 4 + wc) * 2) = (f32x2){s1, s2};
                }
            }
    }
    __device__ __forceinline__ void rope_tile(f32x4 (&acc)[2][2][4][2], const Unit& u, int wr, int wc, int fr, int fq) const {
        const int row0 = u.pm * BM + wr * 64 + fr, col0 = u.pn * BM + wc * 32 + 8 * fq;
        const bool isq = u.pn < 4; const float sc = isq ? QSCALE : 1.f; const bool rotw = (wc & 1) == 0;
#pragma unroll
        for (int ai = 0; ai < 2; ++ai)
#pragma unroll
            for (int m = 0; m < 4; ++m) {
                const int row = row0 + ai * HALF + m * 16; bf16_t* rowp = P + (size_t)row * LDP + col0;
                float cs[8], sn[8];
                if (rotw) { const float pos = (float)(row & (SEQ - 1));
#pragma unroll
                    for (int i = 0; i < 8; ++i) { const float rev = __builtin_amdgcn_fractf(pos * CREV[i]); sn[i] = __builtin_amdgcn_sinf(rev); cs[i] = __builtin_amdgcn_cosf(rev); } }
#pragma unroll
                for (int bj = 0; bj < 2; ++bj) {
                    f32x4 v0 = acc[ai][bj][m][0], v1 = acc[ai][bj][m][1];
                    if (rotw && (isq || bj == 0)) {
                        f32x4 p0, p1;
#pragma unroll
                        for (int e = 0; e < 4; ++e) { p0[e] = __shfl_xor(v0[e], 16); p1[e] = __shfl_xor(v1[e], 16); }
                        if (fq < 2) { const float sg = fq == 0 ? -1.f : 1.f;
#pragma unroll
                            for (int e = 0; e < 4; ++e) { v0[e] = v0[e] * cs[e] + sg * p0[e] * sn[e]; v1[e] = v1[e] * cs[4 + e] + sg * p1[e] * sn[4 + e]; } }
                    }
                    v0 = v0 * sc; v1 = v1 * sc;
                    store8(rowp + bj * HALF, v0, v1);
                }
            }
    }
    __device__ __forceinline__ bool operator()(f32x4 (&acc)[2][2][4][2], const Unit& u, int wr, int wc, int fr, int fq) const {
        const int pn = u.pn;
#if DIAG == 12
        act_tile<0>(acc, u, wr, wc, fr, fq); return false;
#endif
        if (pn <= 4) rope_tile(acc, u, wr, wc, fr, fq);
        else if (pn < 9 || (pn >= 17 && pn < 21)) act_tile<1>(acc, u, wr, wc, fr, fq);
        else if (pn < 13) act_tile<2>(acc, u, wr, wc, fr, fq);
        else if (pn < 17) act_tile<3>(acc, u, wr, wc, fr, fq);
        else act_tile<4>(acc, u, wr, wc, fr, fq);
        return false;
    }
};
struct EpiMerge {
    static constexpr bool PERM = true;
    bf16_t* P;
    __device__ __forceinline__ bool operator()(f32x4 (&acc)[2][2][4][2], const Unit& u, int wr, int wc, int fr, int fq) const {
        const int row0 = u.pm * BM + wr * 64 + fr, col0 = u.pn * BM + wc * 32 + 8 * fq;
        const bool first = (u.src == 0);
#pragma unroll
        for (int ai = 0; ai < 2; ++ai)
#pragma unroll
            for (int m = 0; m < 4; ++m) { bf16_t* rowp = P + (size_t)(row0 + ai * HALF + m * 16) * LDP + col0;
#pragma unroll
                for (int bj = 0; bj < 2; ++bj) {
                    const u32x4 gsw = *(const u32x4*)(rowp + C_GS + bj * HALF);
                    f32x4 s0 = (f32x4){bf_lo(gsw.x), bf_hi(gsw.x), bf_lo(gsw.y), bf_hi(gsw.y)}, s1 = (f32x4){bf_lo(gsw.z), bf_hi(gsw.z), bf_lo(gsw.w), bf_hi(gsw.w)};
                    if (first) {
                        const u32x4 gaw = *(const u32x4*)(rowp + C_GA + bj * HALF);
                        const f32x4 a0 = (f32x4){bf_lo(gaw.x), bf_hi(gaw.x), bf_lo(gaw.y), bf_hi(gaw.y)}, a1 = (f32x4){bf_lo(gaw.z), bf_hi(gaw.z), bf_lo(gaw.w), bf_hi(gaw.w)};
#pragma unroll
                        for (int e = 0; e < 4; ++e) { acc[ai][bj][m][0][e] *= a0[e] / s0[e]; acc[ai][bj][m][1][e] *= a1[e] / s1[e]; }
                    } else {
                        store8(rowp + C_ZA + bj * HALF, acc[ai][bj][m][0] * s0, acc[ai][bj][m][1] * s1);
                    }
                } }
        return first;
    }
};
struct EpiOut {
    static constexpr bool PERM = false;
    const float* x; float* out; float* ssq;
    __device__ __forceinline__ bool operator()(f32x4 (&acc)[2][2][4][2], const Unit& u, int wr, int wc, int fr, int fq) const {
        const int row0 = u.pm * BM + wr * 64 + fr, col0 = u.pn * BM + wc * 32 + 4 * fq;
#pragma unroll
        for (int ai = 0; ai < 2; ++ai)
#pragma unroll
            for (int m = 0; m < 4; ++m) { const int row = row0 + ai * HALF + m * 16; const size_t off = (size_t)row * D + col0; float q = 0.f;
#pragma unroll
                for (int bj = 0; bj < 2; ++bj)
#pragma unroll
                    for (int n = 0; n < 2; ++n) { const f32x4 v = *(const f32x4*)(x + off + bj * HALF + n * 16) + acc[ai][bj][m][n];
                        q += (v[0] * v[0] + v[1] * v[1]) + (v[2] * v[2] + v[3] * v[3]); *(f32x4*)(out + off + bj * HALF + n * 16) = v; }
                q += __shfl_xor(q, 16); q += __shfl_xor(q, 32);
                if (fq == 0) ssq[((size_t)u.pn * M + row) * 4 + wc] = q; }
        return false;
    }
};
}

#define XB_TMO      128
#define XB_XCNT(j)  (256  + 64 * (j))
#define XB_XSUB(j)  (1280 + 64 * (j))
#define XB_XGEN(j)  (2304 + 64 * (j))
#define XB_TOP      3328
#define XB_TOPGEN   3392
#define XCD_BAR_WORDS 3456
#define XB_SPIN_CAP (1u << 22)
__device__ __forceinline__ unsigned xb_ld(unsigned* p)              { return __hip_atomic_load(p, __ATOMIC_RELAXED, __HIP_MEMORY_SCOPE_AGENT); }
__device__ __forceinline__ unsigned xb_add(unsigned* p, unsigned v) { return __hip_atomic_fetch_add(p, v, __ATOMIC_RELAXED, __HIP_MEMORY_SCOPE_AGENT); }
__device__ __forceinline__ unsigned xb_xcc_id() { return (unsigned)__builtin_amdgcn_s_getreg((3 << 11) | 20) & 0xFu; }
#define XB_SPIN(cond, bar) do { unsigned _sp = 0; while (cond) { __builtin_amdgcn_s_sleep(1); \
    if ((++_sp & 255u) == 0u) { if (xb_ld(&(bar)[XB_TMO])) break; if (_sp > XB_SPIN_CAP) { atomicAdd(&(bar)[XB_TMO], 1u); break; } } } } while (0)
struct XcdBarrier { unsigned* bar; unsigned x; volatile LAS unsigned* st; };
__device__ __forceinline__ XcdBarrier xcd_barrier_post(unsigned* bar, volatile LAS unsigned* st) {
    XcdBarrier b; b.bar = bar; b.x = xb_xcc_id(); b.st = st;
    if (threadIdx.x == 0) (void)xb_add(&bar[XB_XCNT(b.x)], 1u);
    return b;
}
__device__ __forceinline__ void xcd_barrier_complete(unsigned* bar, unsigned x, unsigned& nloc, unsigned& nx) {
    const unsigned G = gridDim.x * gridDim.y * gridDim.z;
    unsigned sum, cnt, mine, sp = 0u;
    for (;;) {
        sum = 0u; cnt = 0u; mine = 0u;
#pragma unroll
        for (unsigned j = 0; j < 16; ++j) { const unsigned c = xb_ld(&bar[XB_XCNT(j)]); sum += c; cnt += (c > 0u) ? 1u : 0u; mine = (j == x) ? c : mine; }
        if (sum == G) break;
        __builtin_amdgcn_s_sleep(1);
        if ((++sp & 255u) == 0u) { if (xb_ld(&bar[XB_TMO])) break; if (sp > XB_SPIN_CAP) { atomicAdd(&bar[XB_TMO], 1u); break; } }
    }
    nloc = mine > 0u ? mine : 1u; nx = cnt > 0u ? cnt : 1u;
}
__device__ __forceinline__ void xcd_barrier(const XcdBarrier& b) {
    asm volatile("s_waitcnt vmcnt(0)" ::: "memory");
    __syncthreads();
    if (threadIdx.x == 0) {
        unsigned* bar = b.bar;
        __builtin_amdgcn_s_waitcnt(0);
        unsigned nloc = b.st[0], nx = b.st[1];
        if (nloc == 0u) { xcd_barrier_complete(bar, b.x, nloc, nx); b.st[0] = nloc; b.st[1] = nx; }
        const unsigned old = xb_add(&bar[XB_XSUB(b.x)], 1u);
        const unsigned gen = old / nloc;
        if (old + 1u == (gen + 1u) * nloc) {
            __builtin_amdgcn_fence(__ATOMIC_RELEASE, "agent");
            asm volatile("s_waitcnt vmcnt(0)" ::: "memory");
            const unsigned og = xb_add(&bar[XB_TOP], 1u);
            const unsigned tg = og / nx;
            if (og + 1u == (tg + 1u) * nx) xb_add(&bar[XB_TOPGEN], 1u);
            else XB_SPIN(xb_ld(&bar[XB_TOPGEN]) == tg, bar);
            __builtin_amdgcn_fence(__ATOMIC_ACQUIRE, "agent");
            xb_add(&bar[XB_XGEN(b.x)], 1u);
            asm volatile("s_waitcnt vmcnt(0)" ::: "memory");
        } else {
            XB_SPIN(xb_ld(&bar[XB_XGEN(b.x)]) == gen, bar);
            __builtin_amdgcn_fence(__ATOMIC_ACQUIRE, "agent");
            asm volatile("s_waitcnt vmcnt(0)" ::: "memory");
        }
    }
    __syncthreads();
}

constexpr int RING_BYTES = 131072, MISC_OFF = RING_BYTES + 320, LDS_BYTES = 147456;
constexpr int NWAVES = 8;

__device__ __forceinline__ unsigned f2bf(float f) { unsigned u = __builtin_bit_cast(unsigned, f); return (u + 0x7fffu + ((u >> 16) & 1u)) >> 16; }
__device__ __forceinline__ unsigned pk2(float lo, float hi) { return f2bf(lo) | (f2bf(hi) << 16); }
__device__ __forceinline__ void p0_transpose_item(const float* W, int K, int N, bf16_t* WT, LAS float* scr, int item, int lane) {
    const int nblk = N / 32, kb = item / nblk, nb = item % nblk, k0 = 64 * kb, n0 = 32 * nb;
#pragma unroll 8
    for (int i = 0; i < 32; ++i) { const int kk = 2 * i + (lane >> 5); scr[kk * 33 + (lane & 31)] = W[(size_t)(k0 + kk) * N + n0 + (lane & 31)]; }
    asm volatile("s_waitcnt lgkmcnt(0)" ::: "memory");
    const int c = lane & 7;
#pragma unroll
    for (int j = 0; j < 4; ++j) { const int n = (lane >> 3) + 8 * j; const LAS float* s = scr + (8 * c) * 33 + n;
        u32x4 o; o.x = pk2(s[0 * 33], s[1 * 33]); o.y = pk2(s[2 * 33], s[3 * 33]); o.z = pk2(s[4 * 33], s[5 * 33]); o.w = pk2(s[6 * 33], s[7 * 33]);
        *(u32x4*)(WT + (size_t)(n0 + n) * K + k0 + 8 * c) = o; }
    asm volatile("s_waitcnt lgkmcnt(0)" ::: "memory");
}

constexpr int AT_KP = 144, AT_VP = 400, AT_VOFF = 192 * AT_KP;
__device__ __forceinline__ void attn_unit(LAS unsigned char* lds, bf16_t* P, const float* sinks, int b, int n, int kvh, int tid, int wid, int lane) {
    const int fr = lane & 15, fq = lane >> 4;
    const size_t rowbase = (size_t)b * SEQ;
#pragma unroll
    for (int it = 0; it < 3; ++it) {
        const int idx = tid + 512 * it, kk = idx >> 3, c = idx & 7;
        int t = (n - 2) * 64 + kk; if (t < 0) t += 128;
        const u32x4 v = *(const u32x4*)(P + (rowbase + t) * LDP + C_K + kvh * 64 + c * 8);
        *(LAS u32x4*)(lds + kk * AT_KP + c * 16) = v;
    }
#pragma unroll
    for (int it = 0; it < 3; ++it) {
        const int idx = tid + 512 * it, c = idx / 192, kk = idx - c * 192;
        int t = (n - 2) * 64 + kk; if (t < 0) t += 128;
        const u32x4 v = *(const u32x4*)(P + (rowbase + t) * LDP + C_V + kvh * 64 + c * 8);
        LAS unsigned short* vt = (LAS unsigned short*)(lds + AT_VOFF + (c * 8) * AT_VP + kk * 2);
        vt[0 * (AT_VP / 2)] = (unsigned short)(v.x & 0xffffu); vt[1 * (AT_VP / 2)] = (unsigned short)(v.x >> 16);
        vt[2 * (AT_VP / 2)] = (unsigned short)(v.y & 0xffffu); vt[3 * (AT_VP / 2)] = (unsigned short)(v.y >> 16);
        vt[4 * (AT_VP / 2)] = (unsigned short)(v.z & 0xffffu); vt[5 * (AT_VP / 2)] = (unsigned short)(v.z >> 16);
        vt[6 * (AT_VP / 2)] = (unsigned short)(v.w & 0xffffu); vt[7 * (AT_VP / 2)] = (unsigned short)(v.w >> 16);
    }
    __syncthreads();
    const int h = kvh * 8 + wid;
    const float sink = sinks[h] * LOG2E;
    const int ktmin = n < 2 ? (2 - n) * 4 : 0;
    for (int qt = 0; qt < 4; ++qt) {
        const size_t row = rowbase + (size_t)n * 64 + qt * 16 + fr;
        bf16_t* prow = P + row * LDP;
        bf16x8 qf[2];
#pragma unroll
        for (int ks = 0; ks < 2; ++ks) qf[ks] = *(const bf16x8*)(prow + C_Q + h * 64 + ks * 32 + fq * 8);
        f32x4 s[12];
#pragma unroll
        for (int kt = 0; kt < 12; ++kt) {
            s[kt] = (f32x4){0.f, 0.f, 0.f, 0.f};
#pragma unroll
            for (int ks = 0; ks < 2; ++ks) {
                const bf16x8 kf = *(const LAS bf16x8*)(lds + (16 * kt + fr) * AT_KP + (32 * ks + 8 * fq) * 2);
                s[kt] = __builtin_amdgcn_mfma_f32_16x16x32_bf16(kf, qf[ks], s[kt], 0, 0, 0);
            }
            if (kt < ktmin) s[kt] = (f32x4){-1e30f, -1e30f, -1e30f, -1e30f};
        }
        float mx = sink;
#pragma unroll
        for (int kt = 0; kt < 12; ++kt) mx = fmaxf(mx, fmaxf(fmaxf(s[kt][0], s[kt][1]), fmaxf(s[kt][2], s[kt][3])));
        mx = fmaxf(mx, __shfl_xor(mx, 16)); mx = fmaxf(mx, __shfl_xor(mx, 32));
        float l = 0.f;
#pragma unroll
        for (int kt = 0; kt < 12; ++kt) {
#pragma unroll
            for (int e = 0; e < 4; ++e) { s[kt][e] = __builtin_amdgcn_exp2f(s[kt][e] - mx); l += s[kt][e]; }
        }
        l += __shfl_xor(l, 16); l += __shfl_xor(l, 32);
        l += __builtin_amdgcn_exp2f(sink - mx);
        const float inv = 1.0f / l;
        bf16x8 pb[6];
#pragma unroll
        for (int tp = 0; tp < 6; ++tp) {
            u32x4 w; w.x = cvt_pk_bf16(s[2 * tp][0], s[2 * tp][1]); w.y = cvt_pk_bf16(s[2 * tp][2], s[2 * tp][3]);
            w.z = cvt_pk_bf16(s[2 * tp + 1][0], s[2 * tp + 1][1]); w.w = cvt_pk_bf16(s[2 * tp + 1][2], s[2 * tp + 1][3]);
            pb[tp] = __builtin_bit_cast(bf16x8, w);
        }
#pragma unroll
        for (int dt = 0; dt < 4; ++dt) {
            f32x4 o = (f32x4){0.f, 0.f, 0.f, 0.f};
#pragma unroll
            for (int tp = 0; tp < 6; ++tp) {
                const LAS unsigned char* vp = lds + AT_VOFF + (16 * dt + fr) * AT_VP + (32 * tp + 4 * fq) * 2;
                const u32x2 lo = *(const LAS u32x2*)vp, hi = *(const LAS u32x2*)(vp + 32);
                const u32x4 vw = (u32x4){lo.x, lo.y, hi.x, hi.y};
                o = __builtin_amdgcn_mfma_f32_16x16x32_bf16(__builtin_bit_cast(bf16x8, vw), pb[tp], o, 0, 0, 0);
            }
            const u32x2 zw = *(const u32x2*)(prow + C_ZA + h * 64 + dt * 16 + 4 * fq);
            u32x2 ow; ow.x = cvt_pk_bf16(o[0] * inv * bf_lo(zw.x), o[1] * inv * bf_hi(zw.x)); ow.y = cvt_pk_bf16(o[2] * inv * bf_lo(zw.y), o[3] * inv * bf_hi(zw.y));
            *(u32x2*)(prow + C_Q + h * 64 + dt * 16 + 4 * fq) = ow;
        }
    }
    __syncthreads();
}

constexpr int SG_P = 272, SG_WOFF = 128 * SG_P, SG_STOFF = 2 * 128 * SG_P;
__device__ __forceinline__ void sg_unit(LAS unsigned char* lds, bf16_t* P, const bf16_t* SGW, const float* sg_b, const float* ln_g, const float* ln_b, const float* stats,
                                        int nb, int g, int tid, int wid, int lane) {
    const int fr = lane & 15, fq = lane >> 4;
    const size_t R0 = (size_t)nb * 128;
    if (tid < 128) {
        float s1 = 0.f, s2 = 0.f;
#pragma unroll
        for (int t = 0; t < 4; ++t) { const f32x4* sp = (const f32x4*)(stats + ((size_t)t * M + R0 + tid) * 8);
#pragma unroll
            for (int k = 0; k < 2; ++k) { const f32x4 v = sp[k]; s1 += v[0] + v[2]; s2 += v[1] + v[3]; } }
        const float mean = s1 * (1.0f / 1024.0f); const float var = fmaxf(s2 * (1.0f / 1024.0f) - mean * mean, 0.f);
        *(LAS f32x2*)(lds + SG_STOFF + tid * 8) = (f32x2){mean, 1.0f / sqrtf(var + EPS)};
    }
#pragma unroll
    for (int it = 0; it < 4; ++it) {
        const int idx = tid + 512 * it, i = idx >> 4, ch = idx & 15;
        const u32x4 v = *(const u32x4*)(SGW + ((size_t)g * 128 + i) * 128 + ch * 8);
        *(LAS u32x4*)(lds + SG_WOFF + i * SG_P + ch * 16) = v;
    }
    __syncthreads();
#pragma unroll
    for (int it = 0; it < 4; ++it) {
        const int idx = tid + 512 * it, cch = idx >> 7, j = idx & 127;
        const u32x4 v = *(const u32x4*)(P + (R0 + j) * LDP + C_VS + g * 128 + cch * 8);
        const f32x2 st = *(const LAS f32x2*)(lds + SG_STOFF + j * 8);
        const f32x4 g0 = *(const f32x4*)(ln_g + g * 128 + cch * 8), g1 = *(const f32x4*)(ln_g + g * 128 + cch * 8 + 4);
        const f32x4 b0 = *(const f32x4*)(ln_b + g * 128 + cch * 8), b1 = *(const f32x4*)(ln_b + g * 128 + cch * 8 + 4);
        float x[8] = {bf_lo(v.x), bf_hi(v.x), bf_lo(v.y), bf_hi(v.y), bf_lo(v.z), bf_hi(v.z), bf_lo(v.w), bf_hi(v.w)};
        LAS unsigned short* vt = (LAS unsigned short*)(lds + (cch * 8) * SG_P + j * 2);
#pragma unroll
        for (int e = 0; e < 8; ++e) { const float gg = e < 4 ? g0[e & 3] : g1[e & 3], bb = e < 4 ? b0[e & 3] : b1[e & 3];
            const float y = (x[e] - st.x) * st.y * gg + bb; vt[e * (SG_P / 2)] = (unsigned short)f2bf(y); }
    }
    __syncthreads();
    bf16x8 af[4];
#pragma unroll
    for (int ks = 0; ks < 4; ++ks) af[ks] = *(const LAS bf16x8*)(lds + (16 * wid + fr) * SG_P + (32 * ks + 8 * fq) * 2);
#pragma unroll
    for (int it = 0; it < 8; ++it) {
        f32x4 acc = (f32x4){0.f, 0.f, 0.f, 0.f};
#pragma unroll
        for (int ks = 0; ks < 4; ++ks) {
            if (it < 4 && ks >= 2) continue;
            const bf16x8 wf = *(const LAS bf16x8*)(lds + SG_WOFF + (16 * it + fr) * SG_P + (32 * ks + 8 * fq) * 2);
            acc = __builtin_amdgcn_mfma_f32_16x16x32_bf16(af[ks], wf, acc, 0, 0, 0);
        }
        const int il = 16 * it + fr; const float bs = sg_b[g * 128 + il];
        bf16_t* prow = P + (R0 + il) * LDP + g * 128 + 16 * wid + 4 * fq;
        const u32x2 uw = *(const u32x2*)(prow + C_U), zw = *(const u32x2*)(prow + C_ZS);
        u32x2 ow; ow.x = cvt_pk_bf16(bf_lo(uw.x) * (acc[0] + bs) * bf_lo(zw.x), bf_hi(uw.x) * (acc[1] + bs) * bf_hi(zw.x));
        ow.y = cvt_pk_bf16(bf_lo(uw.y) * (acc[2] + bs) * bf_lo(zw.y), bf_hi(uw.y) * (acc[3] + bs) * bf_hi(zw.y));
        *(u32x2*)(prow + C_U) = ow;
    }
    __syncthreads();
}


#define DIAG_DUMP() do { for (int m = gw; m < M; m += NGW) { const bf16_t* pr = P + (size_t)m * LDP; \
    for (int j = 0; j < 4; ++j) { const int c = (lane + 64 * j) * 4; f32x4 a = (f32x4){0.f, 0.f, 0.f, 0.f}; \
        for (int k = 0; k < 7; ++k) { const u32x2 w = *(const u32x2*)(pr + k * 1024 + c); a += (f32x4){bf_lo(w.x), bf_hi(w.x), bf_lo(w.y), bf_hi(w.y)}; } \
        if (c < 256) { const u32x2 w = *(const u32x2*)(pr + 7168 + c); a += (f32x4){bf_lo(w.x), bf_hi(w.x), bf_lo(w.y), bf_hi(w.y)}; } \
        *(f32x4*)(out + (size_t)m * D + c) = a; } } } while (0)
struct Args { const float* in[13]; float* out; unsigned char* ws; };
__global__ void __launch_bounds__(NWAVES * 64, 2) fwd_megakernel(Args args) {
    extern __shared__ __attribute__((aligned(16))) unsigned char lds_raw[];
    LAS unsigned char* lds = (LAS unsigned char*)lds_raw;
    const int tid = threadIdx.x, lane = tid & 63, wave = __builtin_amdgcn_readfirstlane(tid >> 6);
    const int G = gridDim.x, bx = blockIdx.x;
    unsigned char* ws = args.ws;
    const float* x = args.in[0]; const float* norm_g = args.in[1]; const float* w_in = args.in[2]; const float* b_merge = args.in[3];
    const float* att_sinks = args.in[4]; const float* sg_w = args.in[5]; const float* sg_b = args.in[6]; const float* sg_ln_g = args.in[7];
    const float* sg_ln_b = args.in[8]; const float* w_att_out = args.in[9]; const float* w_sg_out = args.in[10]; const float* w_o = args.in[11];
    const float* final_g = args.in[12];
    float* out = args.out;
    bf16_t* WinT = (bf16_t*)(ws + WS_WIN); bf16_t* WaT = (bf16_t*)(ws + WS_WA); bf16_t* WsT = (bf16_t*)(ws + WS_WS); bf16_t* WoT = (bf16_t*)(ws + WS_WO);
    bf16_t* SGW = (bf16_t*)(ws + WS_SGW); float* SSQ = (float*)(ws + WS_SSQ); bf16_t* P = (bf16_t*)(ws + WS_P);
    bf16_t* XN = (bf16_t*)((unsigned char*)out + OUT_XN); float* STATS = (float*)((unsigned char*)out + OUT_STATS);

    volatile LAS unsigned* MISC = (volatile LAS unsigned*)(lds + MISC_OFF);
    for (int u = tid; u < (LDS_BYTES - RING_BYTES) / 4; u += NWAVES * 64) ((LAS unsigned*)(lds + RING_BYTES))[u] = 0u;
    __syncthreads();
#ifndef USE_XCD_BAR
#define USE_XCD_BAR 1
#endif
#if USE_XCD_BAR
    XcdBarrier bar = xcd_barrier_post((unsigned*)(ws + WS_CTL) + CW_BAR, MISC + 8);
#define GRID_BAR() xcd_barrier(bar)
#else
    (void)MISC;
#define GRID_BAR() cooperative_groups::this_grid().sync()
#endif

    const int gw = bx * NWAVES + wave, NGW = G * NWAVES;
    {
        LAS float* scr = (LAS float*)(lds + wave * 16384);
        constexpr int I_IN = (D / 64) * (NIN / 32), I_SQ = (D / 64) * (D / 32), NITEMS = I_IN + 3 * I_SQ;
        for (int it = gw; it < NITEMS; it += NGW) {
            int r = it;
            if (r < I_IN) { p0_transpose_item(w_in, D, NIN, WinT, scr, r, lane); continue; } r -= I_IN;
            if (r < I_SQ) { p0_transpose_item(w_att_out, D, D, WaT, scr, r, lane); continue; } r -= I_SQ;
            if (r < I_SQ) { p0_transpose_item(w_sg_out, D, D, WsT, scr, r, lane); continue; } r -= I_SQ;
            p0_transpose_item(w_o, D, D, WoT, scr, r, lane);
        }
        for (int c = gw * 64 + lane; c < 8 * 128 * 128 / 8; c += NGW * 64) {
            const f32x4 a = *(const f32x4*)(sg_w + (size_t)c * 8), b = *(const f32x4*)(sg_w + (size_t)c * 8 + 4);
            u32x4 o; o.x = pk2(a[0], a[1]); o.y = pk2(a[2], a[3]); o.z = pk2(b[0], b[1]); o.w = pk2(b[2], b[3]);
            *(u32x4*)(SGW + (size_t)c * 8) = o;
        }
        for (int m = gw; m < M; m += NGW) {
            const f32x4* xr = (const f32x4*)(x + (size_t)m * D) + lane; const f32x4* gr = (const f32x4*)norm_g + lane;
            f32x4 v[4]; float s = 0.f;
#pragma unroll
            for (int j = 0; j < 4; ++j) { v[j] = xr[64 * j]; s += (v[j][0] * v[j][0] + v[j][1] * v[j][1]) + (v[j][2] * v[j][2] + v[j][3] * v[j][3]); }
            const float rstd = 1.0f / sqrtf(wave_sum(s) * (1.0f / D) + EPS);
            unsigned long long* o8 = (unsigned long long*)(XN + (size_t)m * D) + lane;
#pragma unroll
            for (int j = 0; j < 4; ++j) { const f32x4 gv = gr[64 * j];
                o8[64 * j] = (unsigned long long)pk2(v[j][0] * rstd * gv[0], v[j][1] * rstd * gv[1]) | ((unsigned long long)pk2(v[j][2] * rstd * gv[2], v[j][3] * rstd * gv[3]) << 32); }
        }
    }
    GRID_BAR();
#if DIAG == 10
    for (int m = gw; m < M; m += NGW) { for (int j = 0; j < 4; ++j) { const int c = (lane + 64 * j) * 4;
        const u32x2 w0 = *(const u32x2*)(WinT + (size_t)(m % NIN) * D + c), w1 = *(const u32x2*)(WaT + (size_t)(m % D) * D + c), w2 = *(const u32x2*)(WsT + (size_t)(m % D) * D + c), w3 = *(const u32x2*)(WoT + (size_t)(m % D) * D + c);
        const u32x2 w4 = *(const u32x2*)(SGW + (size_t)(m % 128) * D + c);
        f32x4 a = (f32x4){bf_lo(w0.x), bf_hi(w0.x), bf_lo(w0.y), bf_hi(w0.y)}; a += (f32x4){bf_lo(w1.x), bf_hi(w1.x), bf_lo(w1.y), bf_hi(w1.y)}; a += (f32x4){bf_lo(w2.x), bf_hi(w2.x), bf_lo(w2.y), bf_hi(w2.y)};
        a += (f32x4){bf_lo(w3.x), bf_hi(w3.x), bf_lo(w3.y), bf_hi(w3.y)}; a += (f32x4){bf_lo(w4.x), bf_hi(w4.x), bf_lo(w4.y), bf_hi(w4.y)};
        *(f32x4*)(P + (size_t)m * 2 * D + 2 * c) = a; } }
    GRID_BAR();
    for (int m = gw; m < M; m += NGW) { for (int j = 0; j < 4; ++j) { const int c = (lane + 64 * j) * 4; *(f32x4*)(out + (size_t)m * D + c) = *(const f32x4*)(P + (size_t)m * 2 * D + 2 * c); } }
    return;
#endif
#if DIAG == 11
    for (int m = gw; m < M; m += NGW) { for (int j = 0; j < 4; ++j) { const int c = (lane + 64 * j) * 4;
        const u32x2 w0 = *(const u32x2*)(XN + (size_t)m * D + c);
        *(f32x4*)(P + (size_t)m * 2 * D + 2 * c) = (f32x4){bf_lo(w0.x), bf_hi(w0.x), bf_lo(w0.y), bf_hi(w0.y)}; } }
    GRID_BAR();
    for (int m = gw; m < M; m += NGW) { for (int j = 0; j < 4; ++j) { const int c = (lane + 64 * j) * 4; *(f32x4*)(out + (size_t)m * D + c) = *(const f32x4*)(P + (size_t)m * 2 * D + 2 * c); } }
    return;
#endif
    {
        pg8::Gemm g{XN, WinT, XN, WinT, D, D}; pg8::StaticOrder S; S.init(M, NIN, G, bx);
        pg8::EpiProj E{P, b_merge, STATS};
        pg8::gemm_phase<pg8::EpiProj, pg8::StaticOrder>(lds, g, S, E);
    }
    GRID_BAR();
#if DIAG == 1 || DIAG == 12
    DIAG_DUMP(); return;
#endif
    {
        for (int u = bx; u < 512; u += G) { const int b = u >> 8, rem = u & 255; attn_unit(lds, P, att_sinks, b, rem >> 1, rem & 1, tid, wave, lane); }
        for (int u = bx; u < 1024; u += G) sg_unit(lds, P, SGW, sg_b, sg_ln_g, sg_ln_b, STATS, u & 127, u >> 7, tid, wave, lane);
    }
    GRID_BAR();
#if DIAG == 2
    DIAG_DUMP(); return;
#endif
    {
        pg8::Gemm g{P + C_Q, WaT, P + C_U, WsT, LDP, D}; pg8::PairOrder S; S.base.init(M, D, G, bx);
        pg8::EpiMerge E{P};
        pg8::gemm_phase<pg8::EpiMerge, pg8::PairOrder>(lds, g, S, E);
    }
    GRID_BAR();
#if DIAG == 3
    DIAG_DUMP(); return;
#endif
    {
        pg8::Gemm g{P + C_ZA, WoT, P + C_ZA, WoT, LDP, D}; pg8::StaticOrder S; S.init(M, D, G, bx);
        pg8::EpiOut E{x, out, SSQ};
        pg8::gemm_phase<pg8::EpiOut, pg8::StaticOrder>(lds, g, S, E);
    }
    GRID_BAR();
    for (int m = gw; m < M; m += NGW) {
        float s = 0.f;
#pragma unroll
        for (int k = 0; k < 4; ++k) { const f32x4 v = *(const f32x4*)(SSQ + ((size_t)k * M + m) * 4); s += (v[0] + v[1]) + (v[2] + v[3]); }
        const float rstd = 1.0f / sqrtf(s * (1.0f / D) + EPS);
        f32x4* orow = (f32x4*)(out + (size_t)m * D) + lane; const f32x4* gr = (const f32x4*)final_g + lane;
#pragma unroll
        for (int j = 0; j < 4; ++j) { const f32x4 v = orow[64 * j], gv = gr[64 * j]; orow[64 * j] = v * rstd * gv; }
    }
}

extern "C" void kernel_launch(void* const* d_in, const int* in_sizes, int n_in, void* d_out, int out_size, void* d_ws, size_t ws_size, hipStream_t stream) {
    static int grid = 0;
    if (grid == 0) {
        if (n_in != 13 || in_sizes[0] != M * D || out_size != M * D || ws_size < WS_END) { fprintf(stderr, "kernel_launch: unexpected shapes (n_in %d, in0 %d, out %d, ws %zu)\n", n_in, n_in > 0 ? in_sizes[0] : -1, out_size, ws_size); grid = -1; return; }
        int dev = 0, cus = 0, per_cu = 0;
        if (hipGetDevice(&dev) != hipSuccess || hipDeviceGetAttribute(&cus, hipDeviceAttributeMultiprocessorCount, dev) != hipSuccess) { fprintf(stderr, "kernel_launch: device query failed\n"); grid = -1; return; }
        if (hipFuncSetAttribute((const void*)fwd_megakernel, hipFuncAttributeMaxDynamicSharedMemorySize, LDS_BYTES) != hipSuccess) { fprintf(stderr, "kernel_launch: hipFuncSetAttribute failed\n"); grid = -1; return; }
        if (hipOccupancyMaxActiveBlocksPerMultiprocessor(&per_cu, (const void*)fwd_megakernel, NWAVES * 64, LDS_BYTES) != hipSuccess || per_cu < 1) { fprintf(stderr, "kernel_launch: occupancy query says %d blocks per CU\n", per_cu); (void)hipGetLastError(); per_cu = 1; }
        grid = cus;
    }
    if (grid < 0) return;
    if (hipMemsetAsync((char*)d_ws + WS_CTL, 0, CTL_ZERO_BYTES, stream) != hipSuccess) { fprintf(stderr, "kernel_launch: memset failed\n"); return; }
    Args a{};
    for (int i = 0; i < 13; ++i) a.in[i] = (const float*)d_in[i];
    a.out = (float*)d_out; a.ws = (unsigned char*)d_ws;
    void* kargs[] = {&a};
    const hipError_t e = hipLaunchCooperativeKernel((const void*)fwd_megakernel, dim3(grid), dim3(NWAVES * 64), kargs, LDS_BYTES, stream);
    if (e != hipSuccess) fprintf(stderr, "kernel_launch: cooperative launch failed: %s (grid %d)\n", hipGetErrorString(e), grid);
}
```
